# Optimizing an MI355X kernel written in HIP

```python
import math
import jax, jax.numpy as jnp
from jax import lax
import numpy as np

D_MODEL = 1024
BATCH = 2
SEQ = 8192
DEPTH = 2

CHUNK = 64
CONV_WIDTH = D_MODEL // 2
CONV_KERNEL = 31
ATT_HEADS = 4
ATT_HEAD_DIM = 64
ATT_VALUE_DIM = 2 * ATT_HEAD_DIM
ATT_WIDTH = ATT_HEADS * ATT_VALUE_DIM
MIX_WIDTH = CONV_WIDTH + ATT_WIDTH
QK_WIDTH = 2 * ATT_HEADS * ATT_HEAD_DIM
MIX_IN = 2 * CONV_WIDTH + 2 * QK_WIDTH + ATT_WIDTH
OFF_Q = 2 * CONV_WIDTH
OFF_K = OFF_Q + QK_WIDTH
OFF_V = OFF_K + QK_WIDTH
ROPE_THETA = 10000.0
Q_BLOCK = 128
N_GROUPS = 4
EXPERTS_PER_GROUP = 8
N_EXPERTS = N_GROUPS * EXPERTS_PER_GROUP
TOP_K_FINE = 2
D_EXPERT = D_MODEL // 2
MOE_BLOCK = 128
LN_EPS = 1e-5
DEEPNORM_ALPHA = (2.0 * DEPTH) ** 0.25
DEEPNORM_BETA = (8.0 * DEPTH) ** -0.25

kernel_name = "hymba_conformer_diffattn_hiermoe_deepnorm"


def _layernorm(x, g, b):
    xf = x.astype(jnp.float32)
    mu = jnp.mean(xf, axis=-1, keepdims=True)
    var = jnp.mean(jnp.square(xf - mu), axis=-1, keepdims=True)
    return ((xf - mu) * lax.rsqrt(var + LN_EPS) * g.astype(jnp.float32) + b.astype(jnp.float32)).astype(x.dtype)


def _rmsnorm(x, g):
    xf = x.astype(jnp.float32)
    ms = jnp.mean(jnp.square(xf), axis=-1, keepdims=True)
    return (xf * lax.rsqrt(ms + LN_EPS) * g.astype(jnp.float32)).astype(x.dtype)


def _rope_tables(seq):
    half = ATT_HEAD_DIM // 2
    inv_freq = 1.0 / (ROPE_THETA ** (jnp.arange(half, dtype=jnp.float32) * 2.0 / ATT_HEAD_DIM))
    ang = jnp.arange(seq, dtype=jnp.float32)[:, None] * inv_freq[None, :]
    return jnp.cos(ang)[:, None, :], jnp.sin(ang)[:, None, :]


def _rope(x, cos, sin):
    half = ATT_HEAD_DIM // 2
    xf = x.astype(jnp.float32)
    x1, x2 = xf[..., :half], xf[..., half:]
    return jnp.concatenate([x1 * cos - x2 * sin, x2 * cos + x1 * sin], axis=-1).astype(x.dtype)


def _causal_depthwise_conv(u, w, b):
    y = lax.conv_general_dilated(u, w.astype(u.dtype), window_strides=(1,),
                                 padding=[(CONV_KERNEL - 1, 0)],
                                 dimension_numbers=("NWC", "WIO", "NWC"),
                                 feature_group_count=u.shape[-1])
    return y + b


def _diff_attention(q, k, v, lam):
    bsz, seq = q.shape[0], q.shape[1]
    n_blocks = seq // Q_BLOCK
    scale = ATT_HEAD_DIM ** -0.5
    kf = k.astype(jnp.float32)
    vf = v.astype(jnp.float32)
    k_chunk = jnp.arange(seq) // CHUNK
    qb_all = jnp.swapaxes(q.reshape(bsz, n_blocks, Q_BLOCK, 2 * ATT_HEADS, ATT_HEAD_DIM), 0, 1)

    def one_block(args):
        qb, bi = args
        s = jnp.einsum("bqhd,bkhd->bhqk", qb.astype(jnp.float32), kf) * scale
        q_chunk = (bi * Q_BLOCK + jnp.arange(Q_BLOCK)) // CHUNK
        allowed = k_chunk[None, :] <= q_chunk[:, None]
        p = jax.nn.softmax(jnp.where(allowed[None, None], s, -jnp.inf), axis=-1)
        p = p.reshape(bsz, ATT_HEADS, 2, Q_BLOCK, seq)
        a = p[:, :, 0] - lam * p[:, :, 1]
        return jnp.einsum("bhqk,bkhe->bqhe", a, vf).astype(v.dtype)

    o = lax.map(one_block, (qb_all, jnp.arange(n_blocks)))
    return jnp.swapaxes(o, 0, 1).reshape(bsz, seq, ATT_HEADS, ATT_VALUE_DIM)


def _mixer(x, w_in, b_in, conv_w, conv_b, conv_ln_g, conv_ln_b,
           lam_q1, lam_k1, lam_q2, lam_k2, subln_g, w_out, cos, sin, lam_init):
    bsz, seq, _ = x.shape
    proj = x @ w_in + b_in
    u = proj[..., :CONV_WIDTH] * jax.nn.sigmoid(proj[..., CONV_WIDTH:OFF_Q])
    u = _causal_depthwise_conv(u, conv_w, conv_b)
    u = jax.nn.silu(_layernorm(u, conv_ln_g, conv_ln_b))
    q = _rope(proj[..., OFF_Q:OFF_K].reshape(bsz, seq, 2 * ATT_HEADS, ATT_HEAD_DIM), cos, sin)
    k = _rope(proj[..., OFF_K:OFF_V].reshape(bsz, seq, 2 * ATT_HEADS, ATT_HEAD_DIM), cos, sin)
    v = proj[..., OFF_V:].reshape(bsz, seq, ATT_HEADS, ATT_VALUE_DIM)
    lam = (jnp.exp(jnp.sum(lam_q1.astype(jnp.float32) * lam_k1.astype(jnp.float32)))
           - jnp.exp(jnp.sum(lam_q2.astype(jnp.float32) * lam_k2.astype(jnp.float32))) + lam_init)
    o = _diff_attention(q, k, v, lam)
    o = _rmsnorm(o, subln_g) * (1.0 - lam_init)
    merged = jnp.concatenate([u, o.reshape(bsz, seq, ATT_WIDTH)], axis=-1)
    return merged @ w_out


def _hier_moe(x, w_rg, b_rg, w_re, b_re, w_gate_e, w_up_e, w_down_e):
    bsz, seq, d = x.shape
    n_tok = bsz * seq
    xt = x.reshape(n_tok, d)
    pg = jax.nn.softmax((xt @ w_rg + b_rg).astype(jnp.float32), axis=-1)
    grp = jnp.argmax(pg, axis=-1)
    gate_g = jnp.max(pg, axis=-1)
    el = (xt @ w_re + b_re).astype(jnp.float32).reshape(n_tok, N_GROUPS, EXPERTS_PER_GROUP)
    el_g = jnp.take_along_axis(el, grp[:, None, None], axis=1)[:, 0]
    top_v, top_i = lax.top_k(el_g, TOP_K_FINE)
    wts = gate_g[:, None] * jax.nn.softmax(top_v, axis=-1)
    n_assign = n_tok * TOP_K_FINE
    eid = (grp[:, None] * EXPERTS_PER_GROUP + top_i).reshape(n_assign).astype(jnp.int32)
    tok = jnp.repeat(jnp.arange(n_tok, dtype=jnp.int32), TOP_K_FINE)
    w_a = wts.reshape(n_assign)
    order = jnp.argsort(eid)
    eid_s, tok_s, w_s = eid[order], tok[order], w_a[order]
    counts = jnp.zeros((N_EXPERTS,), jnp.int32).at[eid].add(1)
    padded = ((counts + MOE_BLOCK - 1) // MOE_BLOCK) * MOE_BLOCK
    pad_end = jnp.cumsum(padded)
    pad_start = pad_end - padded
    start = jnp.cumsum(counts) - counts
    dest = pad_start[eid_s] + (jnp.arange(n_assign, dtype=jnp.int32) - start[eid_s])
    n_blocks = -(-n_assign // MOE_BLOCK) + N_EXPERTS
    n_rows = n_blocks * MOE_BLOCK
    tok_pad = jnp.zeros((n_rows,), jnp.int32).at[dest].set(tok_s)
    w_pad = jnp.zeros((n_rows,), w_s.dtype).at[dest].set(w_s)
    blk_e = jnp.minimum(jnp.searchsorted(pad_end, jnp.arange(n_blocks, dtype=jnp.int32) * MOE_BLOCK,
                                         side="right"), N_EXPERTS - 1).astype(jnp.int32)

    def expert_block(args):
        tb, e = args
        xb = xt[tb]
        h = jax.nn.silu(xb @ w_gate_e[e]) * (xb @ w_up_e[e])
        return h @ w_down_e[e]

    yb = lax.map(expert_block, (tok_pad.reshape(n_blocks, MOE_BLOCK), blk_e))
    y = yb.reshape(n_rows, d) * w_pad[:, None].astype(x.dtype)
    out = jnp.zeros((n_tok, d), x.dtype).at[tok_pad].add(y)
    return out.reshape(bsz, seq, d)


def setup_inputs(seed: int = 0) -> dict:
    key = jax.random.key(seed)
    ks = jax.random.split(key, 24)
    nrm = jax.random.normal
    f32 = jnp.float32
    x = nrm(ks[0], (BATCH, SEQ, D_MODEL), f32)
    s_in = D_MODEL ** -0.5
    w_in = jnp.concatenate([
        nrm(ks[1], (DEPTH, D_MODEL, OFF_V), f32) * s_in,
        nrm(ks[2], (DEPTH, D_MODEL, ATT_WIDTH), f32) * s_in * DEEPNORM_BETA,
    ], axis=-1)
    b_in = 0.02 * nrm(ks[3], (DEPTH, MIX_IN), f32)
    conv_w = nrm(ks[4], (DEPTH, CONV_KERNEL, 1, CONV_WIDTH), f32) * CONV_KERNEL ** -0.5
    conv_b = 0.02 * nrm(ks[5], (DEPTH, CONV_WIDTH), f32)
    conv_ln_g = 1.0 + 0.05 * nrm(ks[6], (DEPTH, CONV_WIDTH), f32)
    conv_ln_b = 0.02 * nrm(ks[7], (DEPTH, CONV_WIDTH), f32)
    lam_q1 = 0.1 * nrm(ks[8], (DEPTH, ATT_HEAD_DIM), f32)
    lam_k1 = 0.1 * nrm(ks[9], (DEPTH, ATT_HEAD_DIM), f32)
    lam_q2 = 0.1 * nrm(ks[10], (DEPTH, ATT_HEAD_DIM), f32)
    lam_k2 = 0.1 * nrm(ks[11], (DEPTH, ATT_HEAD_DIM), f32)
    subln_g = 1.0 + 0.05 * nrm(ks[12], (DEPTH, ATT_VALUE_DIM), f32)
    w_out = nrm(ks[13], (DEPTH, MIX_WIDTH, D_MODEL), f32) * MIX_WIDTH ** -0.5 * DEEPNORM_BETA
    ln1_g = 1.0 + 0.05 * nrm(ks[14], (DEPTH, D_MODEL), f32)
    ln1_b = 0.02 * nrm(ks[15], (DEPTH, D_MODEL), f32)
    w_rg = nrm(ks[16], (DEPTH, D_MODEL, N_GROUPS), f32) * s_in
    b_rg = 0.01 * nrm(ks[17], (DEPTH, N_GROUPS), f32)
    w_re = nrm(ks[18], (DEPTH, D_MODEL, N_EXPERTS), f32) * s_in
    b_re = 0.01 * nrm(ks[19], (DEPTH, N_EXPERTS), f32)
    w_gate_e = nrm(ks[20], (DEPTH, N_EXPERTS, D_MODEL, D_EXPERT), f32) * s_in
    w_up_e = nrm(ks[21], (DEPTH, N_EXPERTS, D_MODEL, D_EXPERT), f32) * s_in
    w_down_e = nrm(ks[22], (DEPTH, N_EXPERTS, D_EXPERT, D_MODEL), f32) * D_EXPERT ** -0.5 * DEEPNORM_BETA
    k2a, k2b = jax.random.split(ks[23])
    ln2_g = 1.0 + 0.05 * nrm(k2a, (DEPTH, D_MODEL), f32)
    ln2_b = 0.02 * nrm(k2b, (DEPTH, D_MODEL), f32)
    return {"x": x, "w_in": w_in, "b_in": b_in, "conv_w": conv_w, "conv_b": conv_b,
            "conv_ln_g": conv_ln_g, "conv_ln_b": conv_ln_b,
            "lam_q1": lam_q1, "lam_k1": lam_k1, "lam_q2": lam_q2, "lam_k2": lam_k2,
            "subln_g": subln_g, "w_out": w_out, "ln1_g": ln1_g, "ln1_b": ln1_b,
            "w_rg": w_rg, "b_rg": b_rg, "w_re": w_re, "b_re": b_re,
            "w_gate_e": w_gate_e, "w_up_e": w_up_e, "w_down_e": w_down_e,
            "ln2_g": ln2_g, "ln2_b": ln2_b}


def reference(x, w_in, b_in, conv_w, conv_b, conv_ln_g, conv_ln_b,
              lam_q1, lam_k1, lam_q2, lam_k2, subln_g, w_out, ln1_g, ln1_b,
              w_rg, b_rg, w_re, b_re, w_gate_e, w_up_e, w_down_e, ln2_g, ln2_b):
    cos, sin = _rope_tables(x.shape[1])
    for l in range(DEPTH):
        lam_init = 0.8 - 0.6 * math.exp(-0.3 * l)
        m = _mixer(x, w_in[l], b_in[l], conv_w[l], conv_b[l], conv_ln_g[l], conv_ln_b[l],
                   lam_q1[l], lam_k1[l], lam_q2[l], lam_k2[l], subln_g[l], w_out[l],
                   cos, sin, lam_init)
        x = _layernorm(DEEPNORM_ALPHA * x + m, ln1_g[l], ln1_b[l])
        f = _hier_moe(x, w_rg[l], b_rg[l], w_re[l], b_re[l], w_gate_e[l], w_up_e[l], w_down_e[l])
        x = _layernorm(DEEPNORM_ALPHA * x + f, ln2_g[l], ln2_b[l])
    return x
```

```cpp
#include <hip/hip_runtime.h>
#include <cstdint>
#include <cstdio>

constexpr int NB = 2, S_ = 8192, T_ = NB * S_, D_ = 1024, NL = 2;
constexpr int CW = 512, NIN = 2560, OFFQ = 1024, OFFK = 1536, OFFV = 2048;
constexpr int NE = 32, DE = 512, KCONV = 31;
constexpr float ALPHA = 1.4142135623730951f;
constexpr float LN_EPS = 1e-5f;
constexpr float C2 = 0.125f * 1.4426950408889634f;
constexpr int LIST_CAP = 2 * T_;
constexpr int HB_ROWS = 2 * T_ + NE * 256;

constexpr size_t MiB = 1u << 20;
constexpr size_t WS_CTL = 0, CTL_BYTES = 1 * MiB;
constexpr size_t WS_COS = 1 * MiB, WS_SIN = 2 * MiB;
constexpr size_t WS_WIN = 4 * MiB, WS_WOUT = 14 * MiB, WS_WGU = 18 * MiB, WS_WD = 146 * MiB;
constexpr size_t WS_XB = 210 * MiB;
constexpr size_t WS_Q = 242 * MiB, WS_K = 258 * MiB, WS_V = 274 * MiB, WS_U = 290 * MiB, WS_YB = 242 * MiB;
constexpr size_t WS_MG = 306 * MiB, WS_HB = 306 * MiB;
constexpr size_t WS_X1F = 348 * MiB, WS_OT = 348 * MiB;
constexpr size_t WS_X1B = 412 * MiB;
constexpr size_t WS_LIST = 444 * MiB, WS_GATEW = 448 * MiB, WS_XCH = 449 * MiB, WS_END = 452 * MiB;
constexpr int CW_CNT = 1024;

typedef unsigned short bf16_t;
__device__ __forceinline__ float bf2f(bf16_t h) { return __uint_as_float(((unsigned)h) << 16); }
__device__ __forceinline__ bf16_t f2bf(float f) { unsigned u = __float_as_uint(f); return (bf16_t)((u + 0x7fffu + ((u >> 16) & 1u)) >> 16); }
__device__ __forceinline__ float wave_sum(float v) {
#pragma unroll
    for (int o = 1; o < 64; o <<= 1) v += __shfl_xor(v, o);
    return v;
}
__device__ __forceinline__ float sigmoidf_(float x) { return 1.f / (1.f + __expf(-x)); }
__device__ __forceinline__ float lam_init_of(int l) { return 0.8f - 0.6f * expf(-0.3f * (float)l); }
__device__ __forceinline__ float lam_of(const float* q1, const float* k1, const float* q2, const float* k2, int l) {
    float a = 0.f, b = 0.f;
    for (int i = 0; i < 64; ++i) { a += q1[l * 64 + i] * k1[l * 64 + i]; b += q2[l * 64 + i] * k2[l * 64 + i]; }
    return expf(a) - expf(b) + lam_init_of(l);
}

__global__ void k_rope_tables(float* cosT, float* sinT) {
    const int i = blockIdx.x * blockDim.x + threadIdx.x;
    if (i >= S_ * 32) return;
    const int t = i >> 5, d = i & 31;
    const float inv_freq = 1.0f / powf(10000.0f, (float)d * 2.0f / 64.0f);
    const float ang = (float)t * inv_freq;
    const double a = (double)ang;
    const double rev = a * 0.15915494309189535;
    const double fr = rev - floor(rev);
    const float frf = (float)fr;
    cosT[i] = __builtin_amdgcn_cosf(frf);
    sinT[i] = __builtin_amdgcn_sinf(frf);
}

__global__ void __launch_bounds__(256) k_inproj_naive(const float* __restrict__ x, const float* __restrict__ w, const float* __restrict__ bias,
                                                      const float* __restrict__ cosT, const float* __restrict__ sinT,
                                                      bf16_t* U, bf16_t* Q, bf16_t* K, bf16_t* V) {
    const int p = blockIdx.x * 256 + threadIdx.x;
    const int t0 = blockIdx.y * 4;
    int c1, c2;
    if (p < 512) { c1 = p; c2 = 512 + p; }
    else if (p < 768) { const int pp = p - 512; c1 = OFFQ + 64 * (pp >> 5) + (pp & 31); c2 = c1 + 32; }
    else if (p < 1024) { const int pp = p - 768; c1 = OFFK + 64 * (pp >> 5) + (pp & 31); c2 = c1 + 32; }
    else { const int pp = p - 1024; c1 = OFFV + pp; c2 = OFFV + 256 + pp; }
    float a[4] = {0.f, 0.f, 0.f, 0.f}, b[4] = {0.f, 0.f, 0.f, 0.f};
    const float* x0 = x + (size_t)t0 * D_;
    for (int k = 0; k < D_; ++k) {
        const float w1 = w[(size_t)k * NIN + c1], w2 = w[(size_t)k * NIN + c2];
#pragma unroll
        for (int i = 0; i < 4; ++i) { const float xv = x0[(size_t)i * D_ + k]; a[i] += xv * w1; b[i] += xv * w2; }
    }
    const float b1 = bias[c1], b2 = bias[c2];
#pragma unroll
    for (int i = 0; i < 4; ++i) {
        const int t = t0 + i; const float va = a[i] + b1, vb = b[i] + b2;
        if (p < 512) { U[(size_t)t * CW + p] = f2bf(va * sigmoidf_(vb)); }
        else if (p < 1024) {
            const int pp = (p - 512) & 255, d = pp & 31, hh = pp >> 5, pos = t & (S_ - 1);
            const float cs = cosT[pos * 32 + d], sn = sinT[pos * 32 + d];
            float o1 = va * cs - vb * sn, o2 = vb * cs + va * sn;
            bf16_t* dst = (p < 768) ? Q : K; if (p < 768) { o1 *= C2; o2 *= C2; }
            dst[(size_t)t * 512 + 64 * hh + d] = f2bf(o1); dst[(size_t)t * 512 + 64 * hh + d + 32] = f2bf(o2);
        } else { const int pp = p - 1024; V[(size_t)t * 512 + pp] = f2bf(va); V[(size_t)t * 512 + 256 + pp] = f2bf(vb); }
    }
}

__global__ void __launch_bounds__(512) k_conv_naive(const bf16_t* __restrict__ U, const float* __restrict__ cw, const float* __restrict__ cb,
                                                    const float* __restrict__ g, const float* __restrict__ be, bf16_t* MG) {
    __shared__ float red[16];
    const int t = blockIdx.x, c = threadIdx.x, pos = t & (S_ - 1);
    float y = cb[c];
    for (int j = 0; j < KCONV; ++j) { const int pp = pos - (KCONV - 1) + j; if (pp >= 0) y += cw[j * CW + c] * bf2f(U[(size_t)(t - (KCONV - 1) + j) * CW + c]); }
    float s = wave_sum(y);
    if ((c & 63) == 0) red[c >> 6] = s;
    __syncthreads();
    float mean = 0.f; for (int i = 0; i < 8; ++i) mean += red[i]; mean *= (1.f / CW);
    const float dv = y - mean; float s2 = wave_sum(dv * dv);
    if ((c & 63) == 0) red[8 + (c >> 6)] = s2;
    __syncthreads();
    float var = 0.f; for (int i = 0; i < 8; ++i) var += red[8 + i]; var *= (1.f / CW);
    const float z = dv * rsqrtf(var + LN_EPS) * g[c] + be[c];
    MG[(size_t)t * D_ + c] = f2bf(z * sigmoidf_(z));
}

__global__ void __launch_bounds__(64) k_attn_naive(const bf16_t* __restrict__ Q, const bf16_t* __restrict__ K, const bf16_t* __restrict__ V, float* OT) {
    const int chunk = blockIdx.x, m8 = blockIdx.y, b = blockIdx.z;
    const int q = chunk * 64 + threadIdx.x;
    const size_t rowbase = (size_t)b * S_;
    float qv[64];
    { const bf16_t* qp = Q + (rowbase + q) * 512 + 64 * m8;
#pragma unroll
      for (int d = 0; d < 64; ++d) qv[d] = bf2f(qp[d]); }
    const int nk = (chunk + 1) * 64;
    const bf16_t* Kp = K + rowbase * 512 + 64 * m8;
    const bf16_t* Vp = V + rowbase * 512 + 128 * (m8 >> 1);
    float mx = -INFINITY;
    for (int k = 0; k < nk; ++k) {
        const bf16_t* kr = Kp + (size_t)k * 512; float s = 0.f;
#pragma unroll
        for (int d = 0; d < 64; ++d) s += qv[d] * bf2f(kr[d]);
        mx = fmaxf(mx, s);
    }
    float o[128];
#pragma unroll
    for (int d = 0; d < 128; ++d) o[d] = 0.f;
    float l = 0.f;
    for (int k = 0; k < nk; ++k) {
        const bf16_t* kr = Kp + (size_t)k * 512; float s = 0.f;
#pragma unroll
        for (int d = 0; d < 64; ++d) s += qv[d] * bf2f(kr[d]);
        const float p = exp2f(s - mx); l += p;
        const bf16_t* vr = Vp + (size_t)k * 512;
#pragma unroll
        for (int d = 0; d < 128; ++d) o[d] += p * bf2f(vr[d]);
    }
    const float rl = 1.f / l;
    float* op = OT + (((size_t)b * 8 + m8) * S_ + q) * 128;
#pragma unroll
    for (int d = 0; d < 128; ++d) op[d] = o[d] * rl;
}
__global__ void __launch_bounds__(512) k_attn_combine(const float* __restrict__ OT, const float* lq1, const float* lk1, const float* lq2, const float* lk2,
                                                       const float* __restrict__ subg, int layer, bf16_t* MG) {
    __shared__ float red[8];
    const int t = blockIdx.x, b = t / S_, q = t % S_, h = threadIdx.x >> 7, d = threadIdx.x & 127;
    const float lam = lam_of(lq1, lk1, lq2, lk2, layer), li = lam_init_of(layer);
    const float o0 = OT[(((size_t)b * 8 + 2 * h) * S_ + q) * 128 + d], o1 = OT[(((size_t)b * 8 + 2 * h + 1) * S_ + q) * 128 + d];
    const float o = o0 - lam * o1;
    const float s = wave_sum(o * o);
    if ((threadIdx.x & 63) == 0) red[threadIdx.x >> 6] = s;
    __syncthreads();
    const float ms = (red[2 * h] + red[2 * h + 1]) * (1.f / 128.f);
    MG[(size_t)t * D_ + 512 + h * 128 + d] = f2bf(o * rsqrtf(ms + LN_EPS) * subg[layer * 128 + d] * (1.f - li));
}

__global__ void __launch_bounds__(256) k_outproj_naive(const bf16_t* __restrict__ MG, const float* __restrict__ w, const float* __restrict__ xres,
                                                       const float* __restrict__ g, const float* __restrict__ be, float* X1F, bf16_t* X1B) {
    __shared__ float red[4][4];
    const int t0 = blockIdx.x * 4, tid = threadIdx.x;
    float acc[4][4];
#pragma unroll
    for (int i = 0; i < 4; ++i)
#pragma unroll
        for (int j = 0; j < 4; ++j) acc[i][j] = 0.f;
    for (int k = 0; k < D_; ++k) {
        float wv[4];
#pragma unroll
        for (int j = 0; j < 4; ++j) wv[j] = w[(size_t)k * D_ + tid + 256 * j];
#pragma unroll
        for (int i = 0; i < 4; ++i) { const float a = bf2f(MG[(size_t)(t0 + i) * D_ + k]);
#pragma unroll
            for (int j = 0; j < 4; ++j) acc[i][j] += a * wv[j]; }
    }
#pragma unroll
    for (int i = 0; i < 4; ++i) {
        float s = 0.f;
#pragma unroll
        for (int j = 0; j < 4; ++j) { acc[i][j] += ALPHA * xres[(size_t)(t0 + i) * D_ + tid + 256 * j]; s += acc[i][j]; }
        s = wave_sum(s); if ((tid & 63) == 0) red[i][tid >> 6] = s;
    }
    __syncthreads();
    float mean[4];
#pragma unroll
    for (int i = 0; i < 4; ++i) mean[i] = (red[i][0] + red[i][1] + red[i][2] + red[i][3]) * (1.f / D_);
    __syncthreads();
#pragma unroll
    for (int i = 0; i < 4; ++i) {
        float s = 0.f;
#pragma unroll
        for (int j = 0; j < 4; ++j) { const float dv = acc[i][j] - mean[i]; s += dv * dv; }
        s = wave_sum(s); if ((tid & 63) == 0) red[i][tid >> 6] = s;
    }
    __syncthreads();
#pragma unroll
    for (int i = 0; i < 4; ++i) {
        const float rstd = rsqrtf((red[i][0] + red[i][1] + red[i][2] + red[i][3]) * (1.f / D_) + LN_EPS);
#pragma unroll
        for (int j = 0; j < 4; ++j) { const int c = tid + 256 * j; const float v = (acc[i][j] - mean[i]) * rstd * g[c] + be[c];
            X1F[(size_t)(t0 + i) * D_ + c] = v; X1B[(size_t)(t0 + i) * D_ + c] = f2bf(v); }
    }
}

__device__ __forceinline__ void router_token(int tok, int lane, const float* __restrict__ x1f, const float* __restrict__ wrg, const float* __restrict__ brg,
                                             const float* __restrict__ wre, const float* __restrict__ bre, unsigned* cnt, unsigned* list, float* gatew) {
    const float* xr = x1f + (size_t)tok * D_;
    float acc = 0.f;
    if (lane < 36) {
        if (lane < 4) { for (int k = 0; k < D_; ++k) acc += xr[k] * wrg[k * 4 + lane]; acc += brg[lane]; }
        else { const int e = lane - 4; for (int k = 0; k < D_; ++k) acc += xr[k] * wre[k * 32 + e]; acc += bre[e]; }
    }
    float g[4];
#pragma unroll
    for (int i = 0; i < 4; ++i) g[i] = __shfl(acc, i);
    int grp = 0; float gm = g[0];
#pragma unroll
    for (int i = 1; i < 4; ++i) if (g[i] > gm) { gm = g[i]; grp = i; }
    float gs = 0.f;
#pragma unroll
    for (int i = 0; i < 4; ++i) gs += expf(g[i] - gm);
    const float gate_g = 1.f / gs;
    float e8[8];
#pragma unroll
    for (int i = 0; i < 8; ++i) e8[i] = __shfl(acc, 4 + grp * 8 + i);
    int i0 = 0; float v0 = e8[0];
#pragma unroll
    for (int i = 1; i < 8; ++i) if (e8[i] > v0) { v0 = e8[i]; i0 = i; }
    int i1 = -1; float v1 = -INFINITY;
#pragma unroll
    for (int i = 0; i < 8; ++i) if (i != i0 && e8[i] > v1) { v1 = e8[i]; i1 = i; }
    const float p1 = expf(v1 - v0), den = 1.f + p1;
    const float w0 = gate_g / den, w1 = gate_g * p1 / den;
    if (lane < 2) {
        const int e = grp * 8 + (lane == 0 ? i0 : i1);
        const unsigned pos = atomicAdd(&cnt[e], 1u);
        list[(size_t)e * LIST_CAP + pos] = (unsigned)(tok * 2 + lane);
        gatew[tok * 2 + lane] = (lane == 0) ? w0 : w1;
    }
}
__global__ void __launch_bounds__(256) k_router(const float* x1f, const float* wrg, const float* brg, const float* wre, const float* bre,
                                                unsigned* cnt, unsigned* list, float* gatew) {
    const int tok = blockIdx.x * 4 + (threadIdx.x >> 6);
    router_token(tok, threadIdx.x & 63, x1f, wrg, brg, wre, bre, cnt, list, gatew);
}

__device__ __forceinline__ int expert_base(const unsigned* cnt, int e) { int b = 0; for (int i = 0; i < e; ++i) b += (int)((cnt[i] + 255u) & ~255u); return b; }
__global__ void __launch_bounds__(256) k_e1_naive(const bf16_t* __restrict__ X1B, const float* __restrict__ wg, const float* __restrict__ wu,
                                                  const unsigned* cnt, const unsigned* list, bf16_t* HB) {
    const int e = blockIdx.y, g0 = blockIdx.x * 4, n = (int)cnt[e];
    if (g0 >= n) return;
    const int base = expert_base(cnt, e), tid = threadIdx.x;
    int tok[4];
#pragma unroll
    for (int i = 0; i < 4; ++i) tok[i] = (g0 + i < n) ? (int)(list[(size_t)e * LIST_CAP + g0 + i] >> 1) : 0;
    const float* Wg = wg + (size_t)e * D_ * DE; const float* Wu = wu + (size_t)e * D_ * DE;
    float ag[4][2], au[4][2];
#pragma unroll
    for (int i = 0; i < 4; ++i) { ag[i][0] = ag[i][1] = au[i][0] = au[i][1] = 0.f; }
    for (int k = 0; k < D_; ++k) {
        const float g0w = Wg[(size_t)k * DE + tid], g1w = Wg[(size_t)k * DE + tid + 256], u0w = Wu[(size_t)k * DE + tid], u1w = Wu[(size_t)k * DE + tid + 256];
#pragma unroll
        for (int i = 0; i < 4; ++i) { const float a = bf2f(X1B[(size_t)tok[i] * D_ + k]); ag[i][0] += a * g0w; ag[i][1] += a * g1w; au[i][0] += a * u0w; au[i][1] += a * u1w; }
    }
#pragma unroll
    for (int i = 0; i < 4; ++i) if (g0 + i < n) {
#pragma unroll
        for (int j = 0; j < 2; ++j) { const float gg = ag[i][j]; HB[(size_t)(base + g0 + i) * DE + tid + 256 * j] = f2bf(gg * sigmoidf_(gg) * au[i][j]); }
    }
}
__global__ void __launch_bounds__(256) k_e2_naive(const bf16_t* __restrict__ HB, const float* __restrict__ wd, const unsigned* cnt, const unsigned* list,
                                                  const float* gatew, bf16_t* YB) {
    const int e = blockIdx.y, g0 = blockIdx.x * 4, n = (int)cnt[e];
    if (g0 >= n) return;
    const int base = expert_base(cnt, e), tid = threadIdx.x;
    const float* Wd = wd + (size_t)e * DE * D_;
    float acc[4][4];
#pragma unroll
    for (int i = 0; i < 4; ++i)
#pragma unroll
        for (int j = 0; j < 4; ++j) acc[i][j] = 0.f;
    for (int k = 0; k < DE; ++k) {
        float wv[4];
#pragma unroll
        for (int j = 0; j < 4; ++j) wv[j] = Wd[(size_t)k * D_ + tid + 256 * j];
#pragma unroll
        for (int i = 0; i < 4; ++i) { const float a = (g0 + i < n) ? bf2f(HB[(size_t)(base + g0 + i) * DE + k]) : 0.f;
#pragma unroll
            for (int j = 0; j < 4; ++j) acc[i][j] += a * wv[j]; }
    }
#pragma unroll
    for (int i = 0; i < 4; ++i) if (g0 + i < n) {
        const unsigned ent = list[(size_t)e * LIST_CAP + g0 + i]; const float gw = gatew[ent];
#pragma unroll
        for (int j = 0; j < 4; ++j) YB[(size_t)ent * D_ + tid + 256 * j] = f2bf(acc[i][j] * gw);
    }
}

__device__ __forceinline__ void ln2_row(int t, int lane, const float* __restrict__ x1f, const bf16_t* __restrict__ yb, const float* __restrict__ g, const float* __restrict__ be,
                                        float* outf, bf16_t* outb) {
    float v[16]; float s = 0.f;
#pragma unroll
    for (int j = 0; j < 4; ++j) {
        const int c = 256 * j + 4 * lane;
        const float4 xv = *(const float4*)(x1f + (size_t)t * D_ + c);
        const uint2 y0 = *(const uint2*)(yb + (size_t)(2 * t) * D_ + c), y1 = *(const uint2*)(yb + (size_t)(2 * t + 1) * D_ + c);
        v[4 * j + 0] = ALPHA * xv.x + __uint_as_float(y0.x << 16) + __uint_as_float(y1.x << 16);
        v[4 * j + 1] = ALPHA * xv.y + __uint_as_float(y0.x & 0xffff0000u) + __uint_as_float(y1.x & 0xffff0000u);
        v[4 * j + 2] = ALPHA * xv.z + __uint_as_float(y0.y << 16) + __uint_as_float(y1.y << 16);
        v[4 * j + 3] = ALPHA * xv.w + __uint_as_float(y0.y & 0xffff0000u) + __uint_as_float(y1.y & 0xffff0000u);
        s += (v[4 * j] + v[4 * j + 1]) + (v[4 * j + 2] + v[4 * j + 3]);
    }
    const float mean = wave_sum(s) * (1.f / D_); float s2 = 0.f;
#pragma unroll
    for (int i = 0; i < 16; ++i) { v[i] -= mean; s2 += v[i] * v[i]; }
    const float rstd = rsqrtf(wave_sum(s2) * (1.f / D_) + LN_EPS);
#pragma unroll
    for (int j = 0; j < 4; ++j) {
        const int c = 256 * j + 4 * lane;
        const float4 gv = *(const float4*)(g + c), bv = *(const float4*)(be + c);
        float4 o; o.x = v[4 * j] * rstd * gv.x + bv.x; o.y = v[4 * j + 1] * rstd * gv.y + bv.y; o.z = v[4 * j + 2] * rstd * gv.z + bv.z; o.w = v[4 * j + 3] * rstd * gv.w + bv.w;
        *(float4*)(outf + (size_t)t * D_ + c) = o;
        uint2 pk; pk.x = (unsigned)f2bf(o.x) | ((unsigned)f2bf(o.y) << 16); pk.y = (unsigned)f2bf(o.z) | ((unsigned)f2bf(o.w) << 16);
        *(uint2*)(outb + (size_t)t * D_ + c) = pk;
    }
}
__global__ void __launch_bounds__(256) k_ln2(const float* x1f, const bf16_t* yb, const float* g, const float* be, float* outf, bf16_t* outb) {
    ln2_row(blockIdx.x * 4 + (threadIdx.x >> 6), threadIdx.x & 63, x1f, yb, g, be, outf, outb);
}

extern "C" void kernel_launch(void* const* d_in, const int* in_sizes, int n_in, void* d_out, int out_size, void* d_ws, size_t ws_size, hipStream_t stream) {
    if (n_in != 24 || ws_size < WS_END) { fprintf(stderr, "kernel_launch: unexpected n_in %d / ws %zu\n", n_in, ws_size); return; }
    unsigned char* ws = (unsigned char*)d_ws;
    const float* const* in = (const float* const*)d_in;
    float* out = (float*)d_out;
    hipMemsetAsync(ws + WS_CTL, 0, CTL_BYTES, stream);
    unsigned* ctl = (unsigned*)(ws + WS_CTL);
    float* cosT = (float*)(ws + WS_COS); float* sinT = (float*)(ws + WS_SIN);
    bf16_t *XB = (bf16_t*)(ws + WS_XB), *Q = (bf16_t*)(ws + WS_Q), *K = (bf16_t*)(ws + WS_K), *V = (bf16_t*)(ws + WS_V), *U = (bf16_t*)(ws + WS_U), *YB = (bf16_t*)(ws + WS_YB);
    bf16_t *MG = (bf16_t*)(ws + WS_MG), *HB = (bf16_t*)(ws + WS_HB), *X1B = (bf16_t*)(ws + WS_X1B);
    float *X1F = (float*)(ws + WS_X1F), *OT = (float*)(ws + WS_OT), *GW = (float*)(ws + WS_GATEW);
    unsigned* LIST = (unsigned*)(ws + WS_LIST);
    k_rope_tables<<<S_ * 32 / 256, 256, 0, stream>>>(cosT, sinT);
    for (int l = 0; l < NL; ++l) {
        const float* xin = (l == 0) ? in[0] : out;
        k_inproj_naive<<<dim3(5, T_ / 4), 256, 0, stream>>>(xin, in[1] + (size_t)l * D_ * NIN, in[2] + l * NIN, cosT, sinT, U, Q, K, V);
        k_conv_naive<<<T_, 512, 0, stream>>>(U, in[3] + l * KCONV * CW, in[4] + l * CW, in[5] + l * CW, in[6] + l * CW, MG);
        k_attn_naive<<<dim3(S_ / 64, 8, NB), 64, 0, stream>>>(Q, K, V, OT);
        k_attn_combine<<<T_, 512, 0, stream>>>(OT, in[7], in[8], in[9], in[10], in[11], l, MG);
        k_outproj_naive<<<T_ / 4, 256, 0, stream>>>(MG, in[12] + (size_t)l * D_ * D_, xin, in[13] + l * D_, in[14] + l * D_, X1F, X1B);
        unsigned* cnt = ctl + CW_CNT + 64 * l;
        k_router<<<T_ / 4, 256, 0, stream>>>(X1F, in[15] + l * D_ * 4, in[16] + l * 4, in[17] + l * D_ * 32, in[18] + l * 32, cnt, LIST, GW);
        k_e1_naive<<<dim3(LIST_CAP / 4, NE), 256, 0, stream>>>(X1B, in[19] + (size_t)l * NE * D_ * DE, in[20] + (size_t)l * NE * D_ * DE, cnt, LIST, HB);
        k_e2_naive<<<dim3(LIST_CAP / 4, NE), 256, 0, stream>>>(HB, in[21] + (size_t)l * NE * DE * D_, cnt, LIST, GW, YB);
        k_ln2<<<T_ / 4, 256, 0, stream>>>(X1F, YB, in[22] + l * D_, in[23] + l * D_, out, XB);
    }
}
```
